# Optimizing an MI355X kernel written in HIP

```python
import jax, jax.numpy as jnp
from jax import lax
import numpy as np

D_MODEL = 1024
BATCH = 2
SEQ = 8192
DEPTH = 4

N_MIXERS = 4
N_MEM = 256
MIX_WIDTH = D_MODEL
XATTN_HEADS = 4
XATTN_HEAD_DIM = 64
XATTN_WIDTH = XATTN_HEADS * XATTN_HEAD_DIM
TOK_WIDTH = MIX_WIDTH - XATTN_WIDTH

GMLP_CHUNK = 128
GMLP_HEAD_DIM = 128
GMLP_HEADS = TOK_WIDTH // GMLP_HEAD_DIM

HGRN_HEAD_DIM = 128
HGRN_HEADS = TOK_WIDTH // HGRN_HEAD_DIM
HGRN_CHUNK = 16

POOL_WINDOWS = (2, 4, 8, 16)
POOL_GROUP = TOK_WIDTH // len(POOL_WINDOWS)

LRU_HEAD_DIM = 128
LRU_HEADS = TOK_WIDTH // LRU_HEAD_DIM
CONV_WIDTH = 4
LRU_C = 8.0

ALPHA = (2 * DEPTH) ** 0.25
BETA = (8 * DEPTH) ** -0.25
LN_EPS = 1e-5
RMS_EPS = 1e-6

IN_WIDTH_A = 2 * TOK_WIDTH + XATTN_WIDTH + MIX_WIDTH
IN_WIDTH_B = 3 * TOK_WIDTH + XATTN_WIDTH + MIX_WIDTH
IN_WIDTH_C = TOK_WIDTH + XATTN_WIDTH + MIX_WIDTH
IN_WIDTH_D = TOK_WIDTH + XATTN_WIDTH + MIX_WIDTH

kernel_name = 'hybrid_gmlp_hgrn2_pool_rglru_trunk'


def n_of_kind(kind):
    return len(range(kind, DEPTH, N_MIXERS))


def split_cols(t, widths):
    idx = [int(v) for v in np.cumsum(widths)[:-1]]
    return jnp.split(t, idx, axis=-1)


def layer_norm(x, g, b):
    xf = x.astype(jnp.float32)
    mu = jnp.mean(xf, -1, keepdims=True)
    var = jnp.mean(jnp.square(xf - mu), -1, keepdims=True)
    y = (xf - mu) * lax.rsqrt(var + LN_EPS) * g.astype(jnp.float32) + b.astype(jnp.float32)
    return y.astype(x.dtype)


def memory_cross_attention(q, mem_k, mem_v):
    B, S, _ = q.shape
    qh = q.reshape(B, S, XATTN_HEADS, XATTN_HEAD_DIM)
    s = jnp.einsum('bshd,bmhd->bhsm', qh, mem_k).astype(jnp.float32) * (XATTN_HEAD_DIM ** -0.5)
    p = jax.nn.softmax(s, axis=-1).astype(mem_v.dtype)
    o = jnp.einsum('bhsm,bmhd->bshd', p, mem_v)
    return o.reshape(B, S, XATTN_WIDTH).astype(q.dtype)


def chunked_spatial_gating(u, v, w_s, b_s):
    dt = u.dtype
    B, S, _ = v.shape
    n = S // GMLP_CHUNK
    u = jax.nn.gelu(u.astype(jnp.float32))
    v = jax.nn.gelu(v.astype(jnp.float32))
    vg = v.reshape(B, n, GMLP_CHUNK, GMLP_HEADS, GMLP_HEAD_DIM)
    mu = jnp.mean(vg, -1, keepdims=True)
    var = jnp.mean(jnp.square(vg - mu), -1, keepdims=True)
    vn = (vg - mu) * lax.rsqrt(var + LN_EPS)
    causal = jnp.tril(jnp.ones((GMLP_CHUNK, GMLP_CHUNK), dtype=bool))
    w = jnp.where(causal[None], w_s.astype(jnp.float32), 0.0)
    mixed = jnp.einsum('gts,bnsgc->bntgc', w, vn) + b_s.astype(jnp.float32).T[:, :, None]
    return (u * mixed.reshape(B, S, TOK_WIDTH)).astype(dt)


def hgrn2(q, f_logit, i, lb, norm_g):
    dt = q.dtype
    B, S, _ = q.shape
    H, K, C = HGRN_HEADS, HGRN_HEAD_DIM, HGRN_CHUNK
    n = S // C
    f = lb + (1.0 - lb) * jax.nn.sigmoid(f_logit.astype(jnp.float32))
    log_f = jnp.log(f)
    k = 1.0 - f
    qf = jax.nn.silu(q.astype(jnp.float32))
    vf = i.astype(jnp.float32)

    def chunks(t):
        return t.reshape(B, n, C, H, K).transpose(1, 0, 2, 3, 4)

    causal = jnp.tril(jnp.ones((C, C), dtype=bool))

    def step(state, xs):
        qc, kc, vc, lfc = xs
        g = jnp.cumsum(lfc, axis=1)
        g_last = g[:, -1]
        q_dec = qc * jnp.exp(g)
        k_inv = kc * jnp.exp(-g)
        scores = jnp.einsum('bthk,bshk->bhts', q_dec, k_inv)
        scores = jnp.where(causal, scores, 0.0)
        o = (jnp.einsum('bhts,bshv->bthv', scores, vc)
             + jnp.einsum('bthk,bhkv->bthv', q_dec, state))
        k_end = kc * jnp.exp(g_last[:, None] - g)
        state = jnp.exp(g_last)[..., None] * state + jnp.einsum('bshk,bshv->bhkv', k_end, vc)
        return state, o

    s0 = jnp.zeros((B, H, K, K), jnp.float32)
    _, o = lax.scan(step, s0, (chunks(qf), chunks(k), chunks(vf), chunks(log_f)))
    o = o.transpose(1, 0, 2, 3, 4).reshape(B, S, H, K)
    o = o * lax.rsqrt(jnp.mean(jnp.square(o), -1, keepdims=True) + RMS_EPS)
    return (o.reshape(B, S, TOK_WIDTH) * norm_g.astype(jnp.float32)).astype(dt)


def multiscale_pool(p, w_pool, scale):
    dt = p.dtype
    B, S, _ = p.shape
    grp = p.astype(jnp.float32).reshape(B, S, len(POOL_WINDOWS), POOL_GROUP)
    cs = jnp.cumsum(grp, axis=1)
    pos = jnp.arange(S)
    pooled = []
    for g, w in enumerate(POOL_WINDOWS):
        csg = cs[:, :, g]
        prev = jnp.pad(csg, ((0, 0), (w, 0), (0, 0)))[:, :S]
        cnt = jnp.minimum(pos + 1, w).astype(jnp.float32)[None, :, None]
        pooled.append((csg - prev) / cnt)
    pooled = jnp.stack(pooled, axis=2)
    y = jnp.einsum('bsgc,gcd->bsgd', pooled - grp, w_pool.astype(jnp.float32))
    return (y.reshape(B, S, TOK_WIDTH) * scale.astype(jnp.float32)).astype(dt)


def rg_lru_branch(xb, conv_w, conv_b, w_gx, b_gx, w_ga, b_ga, a_param):
    dt = xb.dtype
    B, S, _ = xb.shape
    xc = lax.conv_general_dilated(
        xb, conv_w.astype(dt)[:, None, :], window_strides=(1,),
        padding=[(CONV_WIDTH - 1, 0)], dimension_numbers=('NWC', 'WIO', 'NWC'),
        feature_group_count=TOK_WIDTH) + conv_b.astype(dt)
    xh = xc.astype(jnp.float32).reshape(B, S, LRU_HEADS, LRU_HEAD_DIM)
    gate_x = jax.nn.sigmoid(jnp.einsum('bshi,hij->bshj', xh, w_gx.astype(jnp.float32)) + b_gx.astype(jnp.float32))
    gate_a = jax.nn.sigmoid(jnp.einsum('bshi,hij->bshj', xh, w_ga.astype(jnp.float32)) + b_ga.astype(jnp.float32))
    log_a = -LRU_C * gate_a * jax.nn.softplus(-a_param.astype(jnp.float32).reshape(LRU_HEADS, LRU_HEAD_DIM))
    a = jnp.exp(log_a)
    mult = jnp.sqrt(-jnp.expm1(2.0 * log_a))
    first = (jnp.arange(S) == 0)[None, :, None, None]
    mult = jnp.where(first, 1.0, mult)
    b_term = mult * gate_x * xh

    def combine(l, r):
        a1, b1 = l
        a2, b2 = r
        return a1 * a2, a2 * b1 + b2

    _, h = lax.associative_scan(combine, (a, b_term), axis=1)
    return h.reshape(B, S, TOK_WIDTH).astype(dt)


def setup_inputs(seed: int = 0) -> dict:
    key = jax.random.key(seed)
    ks = jax.random.split(key, 24)
    f32 = jnp.float32

    def nrm(k, shape, scale):
        return jax.random.normal(k, shape, f32) * scale

    nA, nB, nC, nD = n_of_kind(0), n_of_kind(1), n_of_kind(2), n_of_kind(3)
    u = jax.random.uniform(ks[22], (nD, TOK_WIDTH), f32, minval=0.9, maxval=0.999)
    s = u ** (1.0 / LRU_C)
    return {
        'x': nrm(ks[0], (BATCH, SEQ, D_MODEL), 1.0),
        'mem': nrm(ks[1], (BATCH, N_MEM, D_MODEL), 1.0),
        'mem_kv_w': nrm(ks[2], (D_MODEL, 2 * XATTN_WIDTH), D_MODEL ** -0.5),
        'ln_g': 1.0 + nrm(ks[3], (DEPTH, D_MODEL), 0.02),
        'ln_b': nrm(ks[4], (DEPTH, D_MODEL), 0.02),
        'w_out': nrm(ks[5], (DEPTH, MIX_WIDTH, D_MODEL), BETA * MIX_WIDTH ** -0.5),
        'hgrn_lb_logits': 1.0 + nrm(ks[6], (DEPTH, TOK_WIDTH), 0.1),
        'a_w_in': nrm(ks[7], (nA, D_MODEL, IN_WIDTH_A), D_MODEL ** -0.5),
        'a_w_s': nrm(ks[8], (nA, GMLP_HEADS, GMLP_CHUNK, GMLP_CHUNK), GMLP_CHUNK ** -0.5),
        'a_b_s': 1.0 + nrm(ks[9], (nA, GMLP_HEADS, GMLP_CHUNK), 0.02),
        'b_w_in': nrm(ks[10], (nB, D_MODEL, IN_WIDTH_B), D_MODEL ** -0.5),
        'b_norm_g': 1.0 + nrm(ks[11], (nB, TOK_WIDTH), 0.02),
        'c_w_in': nrm(ks[12], (nC, D_MODEL, IN_WIDTH_C), D_MODEL ** -0.5),
        'c_w_pool': nrm(ks[13], (nC, len(POOL_WINDOWS), POOL_GROUP, POOL_GROUP), POOL_GROUP ** -0.5),
        'c_scale': 1.0 + nrm(ks[14], (nC, TOK_WIDTH), 0.02),
        'd_w_in': nrm(ks[15], (nD, D_MODEL, IN_WIDTH_D), D_MODEL ** -0.5),
        'd_conv_w': nrm(ks[16], (nD, CONV_WIDTH, TOK_WIDTH), CONV_WIDTH ** -0.5),
        'd_conv_b': nrm(ks[17], (nD, TOK_WIDTH), 0.02),
        'd_w_gx': nrm(ks[18], (nD, LRU_HEADS, LRU_HEAD_DIM, LRU_HEAD_DIM), LRU_HEAD_DIM ** -0.5),
        'd_b_gx': nrm(ks[19], (nD, LRU_HEADS, LRU_HEAD_DIM), 0.02),
        'd_w_ga': nrm(ks[20], (nD, LRU_HEADS, LRU_HEAD_DIM, LRU_HEAD_DIM), LRU_HEAD_DIM ** -0.5),
        'd_b_ga': nrm(ks[21], (nD, LRU_HEADS, LRU_HEAD_DIM), 0.02),
        'd_a_param': jnp.log(s) - jnp.log1p(-s),
    }


def reference(x, mem, mem_kv_w, ln_g, ln_b, w_out, hgrn_lb_logits,
              a_w_in, a_w_s, a_b_s,
              b_w_in, b_norm_g,
              c_w_in, c_w_pool, c_scale,
              d_w_in, d_conv_w, d_conv_b, d_w_gx, d_b_gx, d_w_ga, d_b_ga, d_a_param):
    B = x.shape[0]
    M = mem.shape[1]
    kv = jnp.einsum('bmd,de->bme', mem, mem_kv_w)
    mem_k = kv[..., :XATTN_WIDTH].reshape(B, M, XATTN_HEADS, XATTN_HEAD_DIM)
    mem_v = kv[..., XATTN_WIDTH:].reshape(B, M, XATTN_HEADS, XATTN_HEAD_DIM)
    lb_p = jax.nn.softmax(hgrn_lb_logits.astype(jnp.float32), axis=0)
    lower_bounds = jnp.cumsum(lb_p, axis=0) - lb_p[0]

    for i in range(DEPTH):
        kind, j = i % N_MIXERS, i // N_MIXERS
        if kind == 0:
            proj = jnp.einsum('bsd,de->bse', x, a_w_in[j])
            u, v, q_x, gate = split_cols(proj, [TOK_WIDTH, TOK_WIDTH, XATTN_WIDTH, MIX_WIDTH])
            tok = chunked_spatial_gating(u, v, a_w_s[j], a_b_s[j])
        elif kind == 1:
            proj = jnp.einsum('bsd,de->bse', x, b_w_in[j])
            q, f_logit, inp, q_x, gate = split_cols(
                proj, [TOK_WIDTH, TOK_WIDTH, TOK_WIDTH, XATTN_WIDTH, MIX_WIDTH])
            tok = hgrn2(q, f_logit, inp, lower_bounds[i], b_norm_g[j])
        elif kind == 2:
            proj = jnp.einsum('bsd,de->bse', x, c_w_in[j])
            p, q_x, gate = split_cols(proj, [TOK_WIDTH, XATTN_WIDTH, MIX_WIDTH])
            tok = multiscale_pool(p, c_w_pool[j], c_scale[j])
        else:
            proj = jnp.einsum('bsd,de->bse', x, d_w_in[j])
            xb, q_x, gate = split_cols(proj, [TOK_WIDTH, XATTN_WIDTH, MIX_WIDTH])
            tok = rg_lru_branch(xb, d_conv_w[j], d_conv_b[j], d_w_gx[j], d_b_gx[j],
                                d_w_ga[j], d_b_ga[j], d_a_param[j])
        xo = memory_cross_attention(q_x, mem_k, mem_v)
        mixed = jnp.concatenate([tok.astype(x.dtype), xo.astype(x.dtype)], axis=-1) * jax.nn.silu(gate)
        y = jnp.einsum('bse,ed->bsd', mixed, w_out[i]).astype(x.dtype)
        x = layer_norm(ALPHA * x + y, ln_g[i], ln_b[i])
    return x
```

```cpp
#include <hip/hip_runtime.h>
#include <hip/hip_cooperative_groups.h>
#include <cstdio>
#include <cstdint>
namespace cg = cooperative_groups;
namespace pg8 {
#define PG8_LAS __attribute__((address_space(3)))
typedef unsigned short bf16_t;
typedef short bf16x8 __attribute__((ext_vector_type(8)));
typedef float f32x4 __attribute__((ext_vector_type(4)));
typedef unsigned u32x4 __attribute__((ext_vector_type(4)));
constexpr int BM = 256, BK = 64, HALF = 128, HTB = HALF * BK * 2  , STAGE_BYTES = 8 * HTB, NXCD = 8, WGM = 8;

__host__ __device__ __forceinline__ int lds_byte(int r, int c) { const int st = (r >> 4) * 2 + (c >> 5), rr = r & 15, cc = c & 31, ob = rr * 64 + cc * 2; return st * 1024 + (ob ^ (((ob >> 9) & 1) << 5)); }
__host__ __device__ __forceinline__ void stage_rc(int b, int& R, int& C) { const int st = b / 1024, sb = b % 1024, swz = sb ^ (((sb >> 9) & 1) << 5); R = (st >> 1) * 16 + swz / 64; C = (st & 1) * 32 + (swz % 64) / 2; }
__host__ __device__ __forceinline__ int perm32(int rho) { const int n = rho >> 4, i = rho & 15; return 8 * (i >> 2) + 4 * n + (i & 3); }

struct Unit { int pm, pn; };
struct Gemm { const bf16_t* A; const bf16_t* Bt; int M, N, K; };

struct StaticOrder {
    int nM, nN, nwg, G, c;
    __host__ __device__ void init(int M, int N, int G_, int c_) { nM = M / BM; nN = N / BM; nwg = nM * nN; G = G_; c = c_; }
    __host__ __device__ bool next(int i, Unit& u) const {
        const long L = (long)i * G + c; if (L >= nwg) return false;
        int wgid = (int)L; { const int q = nwg / NXCD, r = nwg % NXCD, xcd = wgid % NXCD, off = wgid / NXCD; wgid = (xcd < r ? xcd * (q + 1) : r * (q + 1) + (xcd - r) * q) + off; }
        const int nig = WGM * nN, gid = wgid / nig, fm = gid * WGM, gsz = (nM - fm) < WGM ? (nM - fm) : WGM;
        u.pm = fm + ((wgid % nig) % gsz); u.pn = (wgid % nig) / gsz; return true;
    }
    __device__ __forceinline__ void a_ready(const Unit&) const {}
    __device__ __forceinline__ void done(const Unit&) const {}
};

__device__ __forceinline__ unsigned cvt_pk_bf16(float lo, float hi) { unsigned r; asm volatile("v_cvt_pk_bf16_f32 %0, %1, %2" : "=v"(r) : "v"(lo), "v"(hi)); return r; }
typedef float f32x2 __attribute__((ext_vector_type(2)));
__device__ __forceinline__ f32x2 gelu_pk(f32x2 v) {
    const f32x2 av = __builtin_elementwise_abs(v), d = av * 0.2316418882f + 1.0f;
    f32x2 t; t.x = __builtin_amdgcn_rcpf(d.x); t.y = __builtin_amdgcn_rcpf(d.y);
    f32x2 q = t * 0.5307027145f + (-0.7265760135f); q = q * t + 0.7107068705f; q = q * t + (-0.142248368f); q = q * t + 0.127414796f; q = q * t;
    const f32x2 s = (v * v) * (-0.72134752044f);
    f32x2 e; e.x = __builtin_amdgcn_exp2f(s.x); e.y = __builtin_amdgcn_exp2f(s.y);
    const f32x2 m = v * (q * e), r = v - m;
    f32x2 o; o.x = v.x < 0.f ? m.x : r.x; o.y = v.y < 0.f ? m.y : r.y; return o;
}

template <int ACT  > struct EpiBf16 {
    static constexpr bool PERM = true, AFTER_DRAIN = false; static_assert(ACT == 0 || ACT == 1, "EpiBf16: ACT is 0 (none) or 1 (gelu_pk)");
    bf16_t* O; int ldc; const float* bias; int split_cols; size_t split_stride; float scale0;
    __device__ __forceinline__ void operator()(const f32x4 (&acc)[2][2][4][2], const Unit& u, int wr, int wc, int fr, int fq) const {
        const int row0 = u.pm * BM + wr * 64 + fr; int colt = u.pn * BM; bf16_t* base = O;
        float sc = 1.f; if (split_cols) { const int t = colt / split_cols; base += (size_t)t * split_stride; colt -= t * split_cols; if (t == 0) sc = scale0; }
        const int col0 = colt + wc * 32 + 8 * fq, bcol0 = u.pn * BM + wc * 32 + 8 * fq;
        f32x4 bv[2][2];
#pragma unroll
        for (int bj = 0; bj < 2; ++bj)
#pragma unroll
            for (int n = 0; n < 2; ++n) bv[bj][n] = bias ? *(const f32x4*)(bias + bcol0 + bj * HALF + 4 * n) : (f32x4){0.f, 0.f, 0.f, 0.f};
#pragma unroll
        for (int ai = 0; ai < 2; ++ai)
#pragma unroll
            for (int m = 0; m < 4; ++m) { bf16_t* rowp = base + (size_t)(row0 + ai * HALF + m * 16) * ldc + col0;
#pragma unroll
                for (int bj = 0; bj < 2; ++bj) { f32x4 v0 = acc[ai][bj][m][0] + bv[bj][0], v1 = acc[ai][bj][m][1] + bv[bj][1];
                    if (ACT == 1) { f32x2 a = gelu_pk((f32x2){v0[0], v0[1]}), b = gelu_pk((f32x2){v0[2], v0[3]}), c = gelu_pk((f32x2){v1[0], v1[1]}), d = gelu_pk((f32x2){v1[2], v1[3]});
                        v0 = (f32x4){a.x, a.y, b.x, b.y}; v1 = (f32x4){c.x, c.y, d.x, d.y}; }
                    v0 = v0 * sc; v1 = v1 * sc; u32x4 w; w.x = cvt_pk_bf16(v0[0], v0[1]); w.y = cvt_pk_bf16(v0[2], v0[3]); w.z = cvt_pk_bf16(v1[0], v1[1]); w.w = cvt_pk_bf16(v1[2], v1[3]);
                    *(u32x4*)(rowp + bj * HALF) = w; } }
    }
};
template <class Epi, class Sched, bool ALIGN_EPI = false, bool SP2 = false>
__device__ __forceinline__ void gemm_phase(PG8_LAS unsigned char* lds, const Gemm g, const Sched& S, const Epi& E) {
    const int tid = threadIdx.x, wid = __builtin_amdgcn_readfirstlane(tid >> 6), lane = tid & 63, wr = wid >> 2, wc = wid & 3, fr = lane & 15, fq = lane >> 4;
    const int K = g.K, nt = K / BK;
    unsigned voffA[2], voffB[2];
#pragma unroll
    for (int i = 0; i < 2; ++i) { int R, C; stage_rc(tid * 16 + i * 8192, R, C); const int Rb = Epi::PERM ? ((R & ~31) + perm32(R & 31)) : R;
        voffA[i] = (unsigned)(R * K + C) * 2u; voffB[i] = (unsigned)(Rb * K + C) * 2u; }
    const size_t kstep = (size_t)(BK * 2);
    const size_t hstep = (size_t)HALF * K * 2;
    const size_t tstep = 2 * hstep;
    const unsigned ldsw = (unsigned)wid * 1024u;
    const int aoff = lds_byte(wr * 64 + fr, fq * 8), boff = lds_byte(wc * 32 + fr, fq * 8);
#define PG8_SA(b, h) (((b) * 2 + (h)) * HTB)
#define PG8_SB(b, h) ((4 + (b) * 2 + (h)) * HTB)
#define PG8_STAGE(bufoff, gbase, voff) do { _Pragma("unroll") for (int _i = 0; _i < 2; ++_i) \
        __builtin_amdgcn_global_load_lds((const unsigned*)((const char*)(gbase) + (voff)[_i]), (PG8_LAS unsigned*)(lds + (bufoff) + ldsw + _i * 8192), 16, 0, 0); } while (0)
#define PG8_LDA(dst, b, h) do { _Pragma("unroll") for (int m = 0; m < 4; ++m) _Pragma("unroll") for (int k = 0; k < 2; ++k) dst[m][k] = *(const PG8_LAS bf16x8*)(lds + PG8_SA(b, h) + aoff + m * 2048 + k * 1024); } while (0)
#define PG8_LDB(dst, b, h) do { _Pragma("unroll") for (int n = 0; n < 2; ++n) _Pragma("unroll") for (int k = 0; k < 2; ++k) dst[n][k] = *(const PG8_LAS bf16x8*)(lds + PG8_SB(b, h) + boff + n * 2048 + k * 1024); } while (0)
#define PG8_MMA(ai, bj, At, Bt) do { __builtin_amdgcn_s_setprio(1); _Pragma("unroll") for (int m = 0; m < 4; ++m) _Pragma("unroll") for (int n = 0; n < 2; ++n) _Pragma("unroll") for (int k = 0; k < 2; ++k) \
        acc[ai][bj][m][n] = __builtin_amdgcn_mfma_f32_16x16x32_bf16(Bt[n][k], At[m][k], acc[ai][bj][m][n], 0, 0, 0); __builtin_amdgcn_s_setprio(0); } while (0)
#define PG8_WAIT_V(n) asm volatile("s_waitcnt vmcnt(" #n ")" ::: "memory")
#define PG8_WAIT_L(n) asm volatile("s_waitcnt lgkmcnt(" #n ")" ::: "memory")
#define PG8_BAR __builtin_amdgcn_s_barrier()
#define PG8_SCHED __builtin_amdgcn_sched_barrier(0)
    Unit cur, nxt; int ui = 0;
    if (!S.next(0, cur)) return;
    f32x4 acc[2][2][4][2];
#pragma unroll
    for (int a = 0; a < 2; ++a)
#pragma unroll
        for (int b = 0; b < 2; ++b)
#pragma unroll
            for (int m = 0; m < 4; ++m)
#pragma unroll
                for (int n = 0; n < 2; ++n) acc[a][b][m][n] = (f32x4){0.f, 0.f, 0.f, 0.f};
    bf16x8 At[4][2], B0[2][2], B1[2][2];
    const char* cA = (const char*)g.A + (size_t)cur.pm * tstep; const char* cB = (const char*)g.Bt + (size_t)cur.pn * tstep;
    S.a_ready(cur);
    if constexpr (SP2) {
        PG8_STAGE(PG8_SB(0, 0), cB, voffB); PG8_STAGE(PG8_SB(0, 1), cB + hstep, voffB); PG8_STAGE(PG8_SA(0, 0), cA, voffA); PG8_STAGE(PG8_SA(0, 1), cA + hstep, voffA);
        if (wr == 1) PG8_BAR;
        PG8_WAIT_V(2); PG8_BAR;
        PG8_STAGE(PG8_SB(1, 0), cB + kstep, voffB); PG8_STAGE(PG8_SA(1, 0), cA + kstep, voffA); PG8_STAGE(PG8_SB(1, 1), cB + hstep + kstep, voffB);
        PG8_WAIT_V(6); PG8_BAR;
    } else {
        PG8_STAGE(PG8_SB(0, 0), cB, voffB); PG8_STAGE(PG8_SA(0, 0), cA, voffA); PG8_STAGE(PG8_SB(0, 1), cB + hstep, voffB); PG8_STAGE(PG8_SA(0, 1), cA + hstep, voffA);
        if (wr == 1) PG8_BAR;
        PG8_WAIT_V(4); PG8_BAR;
        PG8_STAGE(PG8_SB(1, 0), cB + kstep, voffB); PG8_STAGE(PG8_SA(1, 0), cA + kstep, voffA); PG8_STAGE(PG8_SB(1, 1), cB + hstep + kstep, voffB);
        PG8_WAIT_V(6); PG8_BAR;
    }
    for (;;) {
        const bool has_next = S.next(ui + 1, nxt);
        const char* nA = has_next ? (const char*)g.A + (size_t)nxt.pm * tstep : cA; const char* nB = has_next ? (const char*)g.Bt + (size_t)nxt.pn * tstep : cB;
        for (int t = 0; t < nt; t += 2) {
            const bool last = (t == nt - 2);
            const char* a1 = cA + (size_t)(t + 1) * kstep;
            const char* a2 = last ? nA : cA + (size_t)(t + 2) * kstep; const char* b2 = last ? nB : cB + (size_t)(t + 2) * kstep;
            const char* a3 = a2 + kstep; const char* b3 = b2 + kstep;
            if (last && has_next) S.a_ready(nxt);
            if constexpr (SP2) {
            PG8_LDB(B0, 0, 0); PG8_LDB(B1, 0, 1); PG8_SCHED; PG8_LDA(At, 0, 0); PG8_STAGE(PG8_SA(1, 1), a1 + hstep, voffA);
            PG8_WAIT_V(8); PG8_WAIT_L(0); PG8_BAR; PG8_MMA(0, 0, At, B0); PG8_MMA(0, 1, At, B1); PG8_BAR; PG8_SCHED;
            PG8_LDA(At, 0, 1); PG8_STAGE(PG8_SB(0, 0), b2, voffB); PG8_STAGE(PG8_SB(0, 1), b2 + hstep, voffB); PG8_STAGE(PG8_SA(0, 0), a2, voffA);
            PG8_WAIT_V(8); PG8_WAIT_L(0); PG8_BAR; PG8_MMA(1, 0, At, B0); PG8_MMA(1, 1, At, B1); PG8_BAR; PG8_SCHED;
            PG8_LDB(B0, 1, 0); PG8_LDB(B1, 1, 1); PG8_SCHED; PG8_LDA(At, 1, 0); PG8_STAGE(PG8_SA(0, 1), a2 + hstep, voffA);
            PG8_WAIT_V(8); PG8_WAIT_L(0); PG8_BAR; PG8_MMA(0, 0, At, B0); PG8_MMA(0, 1, At, B1); PG8_BAR; PG8_SCHED;
            PG8_LDA(At, 1, 1); PG8_STAGE(PG8_SB(1, 0), b3, voffB); PG8_STAGE(PG8_SB(1, 1), b3 + hstep, voffB); PG8_STAGE(PG8_SA(1, 0), a3, voffA);
            PG8_WAIT_V(8); PG8_WAIT_L(0); PG8_BAR; PG8_MMA(1, 0, At, B0); PG8_MMA(1, 1, At, B1); PG8_BAR; PG8_SCHED;
            } else {
            PG8_LDB(B0, 0, 0); PG8_SCHED; PG8_LDA(At, 0, 0); PG8_STAGE(PG8_SA(1, 1), a1 + hstep, voffA);
            PG8_WAIT_L(8); PG8_BAR; PG8_WAIT_L(0); PG8_MMA(0, 0, At, B0); PG8_BAR; PG8_SCHED;
            PG8_LDB(B1, 0, 1); PG8_STAGE(PG8_SB(0, 0), b2, voffB);
            PG8_BAR; PG8_WAIT_L(0); PG8_MMA(0, 1, At, B1); PG8_BAR;
            PG8_LDA(At, 0, 1); PG8_STAGE(PG8_SA(0, 0), a2, voffA);
            PG8_BAR; PG8_WAIT_L(0); PG8_MMA(1, 0, At, B0); PG8_BAR; PG8_SCHED;
            PG8_STAGE(PG8_SB(0, 1), b2 + hstep, voffB);
            PG8_WAIT_V(6); PG8_BAR; PG8_MMA(1, 1, At, B1); PG8_BAR;
            PG8_LDB(B0, 1, 0); PG8_SCHED; PG8_LDA(At, 1, 0); PG8_STAGE(PG8_SA(0, 1), a2 + hstep, voffA);
            PG8_WAIT_L(8); PG8_BAR; PG8_WAIT_L(0); PG8_MMA(0, 0, At, B0); PG8_BAR; PG8_SCHED;
            PG8_LDB(B1, 1, 1); PG8_STAGE(PG8_SB(1, 0), b3, voffB);
            PG8_BAR; PG8_WAIT_L(0); PG8_MMA(0, 1, At, B1); PG8_BAR;
            PG8_LDA(At, 1, 1); PG8_STAGE(PG8_SA(1, 0), a3, voffA);
            PG8_BAR; PG8_WAIT_L(0); PG8_MMA(1, 0, At, B0); PG8_BAR; PG8_SCHED;
            PG8_STAGE(PG8_SB(1, 1), b3 + hstep, voffB);
            PG8_WAIT_V(6); PG8_BAR; PG8_MMA(1, 1, At, B1); PG8_BAR;
            }
        }
        if constexpr (ALIGN_EPI) { if (wr == 0) PG8_BAR; }
        if constexpr (!Epi::AFTER_DRAIN) { E(acc, cur, wr, wc, fr, fq); S.done(cur); }
        if (!has_next) break;
#pragma unroll
        for (int a = 0; a < 2; ++a)
#pragma unroll
            for (int b = 0; b < 2; ++b)
#pragma unroll
                for (int m = 0; m < 4; ++m)
#pragma unroll
                    for (int n = 0; n < 2; ++n) acc[a][b][m][n] = (f32x4){0.f, 0.f, 0.f, 0.f};
        cur = nxt; cA = nA; cB = nB; ++ui;
        if constexpr (ALIGN_EPI) { if (wr == 1) PG8_BAR; }
    }
    PG8_WAIT_V(0);
    if constexpr (!ALIGN_EPI) { if (wr == 0) PG8_BAR; }
    PG8_BAR;
    if constexpr (Epi::AFTER_DRAIN) { E.fused(acc, cur, wr, wc, fr, fq, lds, wid, lane); S.done(cur); }
#undef PG8_SA
#undef PG8_SB
#undef PG8_STAGE
#undef PG8_LDA
#undef PG8_LDB
#undef PG8_MMA
#undef PG8_WAIT_V
#undef PG8_WAIT_L
#undef PG8_BAR
#undef PG8_SCHED
}
}

#define LAS __attribute__((address_space(3)))
typedef unsigned short bf16_t;
typedef short bf16x8 __attribute__((ext_vector_type(8)));
typedef float f32x4 __attribute__((ext_vector_type(4)));
typedef float f32x2 __attribute__((ext_vector_type(2)));
typedef unsigned u32x4 __attribute__((ext_vector_type(4)));
typedef unsigned u32x2 __attribute__((ext_vector_type(2)));
typedef LAS unsigned char* ldsp;

constexpr int M = 16384, D = 1024, SEQ = 8192;
constexpr int WIN0 = 2816, WIN1 = 3584, WIN2 = 2048, WIN3 = 2048;
constexpr float ALPHA = 1.681792830507429f;
constexpr float LN_EPS = 1e-5f, RMS_EPS = 1e-6f;
constexpr size_t MiB = 1u << 20;
constexpr size_t WS_WIN0 = 1 * MiB, WS_WIN1 = 7 * MiB, WS_WIN2 = 14 * MiB, WS_WIN3 = 18 * MiB, WS_WOUT = 22 * MiB, WS_WKV = 30 * MiB;
constexpr size_t WS_WSB = 31 * MiB, WS_WPT = WS_WSB + 196608, WS_WGX = WS_WPT + 294912, WS_WGA = WS_WGX + 196608;
constexpr size_t WS_XN = 32 * MiB, WS_STATE = 32 * MiB  ;
constexpr size_t WS_MEMB = 80 * MiB, WS_KB = 81 * MiB, WS_VT = WS_KB + 262144, WS_DEC = WS_VT + 262144, WS_LSUM = WS_DEC + 786432;
constexpr size_t WS_PROJ = 84 * MiB, WS_MIXED = 196 * MiB, WS_END = 228 * MiB;
constexpr int LDS_BYTES = 147456;
constexpr int NPH = 20;
#ifndef EN_XATTN
#define EN_XATTN 1
#endif
#ifndef EN_GMLP
#define EN_GMLP 1
#endif
#ifndef EN_HGRN
#define EN_HGRN 1
#endif
#ifndef EN_POOL
#define EN_POOL 1
#endif
#ifndef EN_LRU
#define EN_LRU 1
#endif
#ifndef EN_PRO
#define EN_PRO 1
#endif
#ifndef EN_LN
#define EN_LN 1
#endif
#ifndef EN_GEMM
#define EN_GEMM 1
#endif

__device__ __forceinline__ float bf2f(unsigned short v) { return __uint_as_float(((unsigned)v) << 16); }
__device__ __forceinline__ unsigned f2bf(float f) { unsigned u = __float_as_uint(f); return (u + 0x7fffu + ((u >> 16) & 1u)) >> 16; }
__device__ __forceinline__ unsigned pk2(float lo, float hi) { return f2bf(lo) | (f2bf(hi) << 16); }
__device__ __forceinline__ float lo16(unsigned w) { return __uint_as_float(w << 16); }
__device__ __forceinline__ float hi16(unsigned w) { return __uint_as_float(w & 0xffff0000u); }
__device__ __forceinline__ float sigmoidf_(float x) { return 1.0f / (1.0f + __expf(-x)); }
__device__ __forceinline__ float siluf_(float x) { return x / (1.0f + __expf(-x)); }
__device__ __forceinline__ float geluf_(float x) { const float u = 1.5957691216057308f * (x + 0.044715f * x * x * x); return x / (1.0f + __expf(-u)); }
__device__ __forceinline__ bf16x8 ld8(const bf16_t* p) { return *(const bf16x8*)p; }
__device__ __forceinline__ bf16x8 lds8(ldsp base, int elem) { return *(const LAS bf16x8*)(base + elem * 2); }
#define MFMA16(w, x, acc) __builtin_amdgcn_mfma_f32_16x16x32_bf16((w), (x), (acc), 0, 0, 0)

template <int N> __device__ __forceinline__ float row_shr(float oldv, float v) {
    return __int_as_float(__builtin_amdgcn_update_dpp(__float_as_int(oldv), __float_as_int(v), 0x110 + N, 0xf, 0xf, false));
}

struct Args { const float* in[23]; float* out; unsigned char* ws; int ph_lo, ph_hi; };

struct EpiResid {
    static constexpr bool PERM = false, AFTER_DRAIN = false;
    const float* base; float* out; float alpha;
    __device__ __forceinline__ void operator()(const pg8::f32x4 (&acc)[2][2][4][2], const pg8::Unit& u, int wr, int wc, int fr, int fq) const {
        const int col0 = u.pn * 256 + wc * 32 + 4 * fq;
#pragma unroll
        for (int ai = 0; ai < 2; ++ai)
#pragma unroll
            for (int m = 0; m < 4; ++m) { const size_t off = (size_t)(u.pm * 256 + ai * 128 + wr * 64 + m * 16 + fr) * D + col0;
#pragma unroll
                for (int bj = 0; bj < 2; ++bj)
#pragma unroll
                    for (int n = 0; n < 2; ++n) { const f32x4 b = *(const f32x4*)(base + off + bj * 128 + n * 16); *(f32x4*)(out + off + bj * 128 + n * 16) = b * alpha + acc[ai][bj][m][n]; } }
    }
};
struct EpiKV {
    static constexpr bool PERM = false, AFTER_DRAIN = false;
    bf16_t* KB; bf16_t* VT;
    __device__ __forceinline__ void operator()(const pg8::f32x4 (&acc)[2][2][4][2], const pg8::Unit& u, int wr, int wc, int fr, int fq) const {
        const int col0 = wc * 32 + 4 * fq;
#pragma unroll
        for (int ai = 0; ai < 2; ++ai)
#pragma unroll
            for (int m = 0; m < 4; ++m) { const int r = u.pm * 256 + ai * 128 + wr * 64 + m * 16 + fr;
#pragma unroll
                for (int bj = 0; bj < 2; ++bj)
#pragma unroll
                    for (int n = 0; n < 2; ++n) { const int c = col0 + bj * 128 + n * 16; const f32x4 v = acc[ai][bj][m][n];
                        if (u.pn == 0) { u32x2 w; w.x = pk2(v[0], v[1]); w.y = pk2(v[2], v[3]); *(u32x2*)(KB + (size_t)r * 256 + c) = w; }
                        else {
#pragma unroll
                            for (int e = 0; e < 4; ++e) VT[((size_t)(r >> 8) * 256 + c + e) * 256 + (r & 255)] = (bf16_t)f2bf(v[e]); } } }
    }
};

__device__ __forceinline__ void transpose_item(const float* W, int K, int N, bf16_t* WT, LAS float* scr, int item, int lane) {
    const int nblk = N / 32, kb = item / nblk, nb = item % nblk, k0 = 64 * kb, n0 = 32 * nb;
#pragma unroll 8
    for (int i = 0; i < 32; ++i) { const int kk = 2 * i + (lane >> 5); scr[kk * 33 + (lane & 31)] = W[(size_t)(k0 + kk) * N + n0 + (lane & 31)]; }
    __builtin_amdgcn_wave_barrier(); asm volatile("s_waitcnt lgkmcnt(0)" ::: "memory");
    const int c = lane & 7;
#pragma unroll
    for (int j = 0; j < 4; ++j) { const int n = (lane >> 3) + 8 * j; const LAS float* s = scr + (8 * c) * 33 + n;
        u32x4 o; o.x = pk2(s[0 * 33], s[1 * 33]); o.y = pk2(s[2 * 33], s[3 * 33]); o.z = pk2(s[4 * 33], s[5 * 33]); o.w = pk2(s[6 * 33], s[7 * 33]);
        *(u32x4*)(WT + (size_t)(n0 + n) * K + k0 + 8 * c) = o; }
    __builtin_amdgcn_wave_barrier(); asm volatile("s_waitcnt lgkmcnt(0)" ::: "memory");
}
__device__ __forceinline__ void cvt_rows(const float* src, bf16_t* dst, size_t n8, size_t gtid, size_t nthr) {
    for (size_t i = gtid; i < n8; i += nthr) { const f32x4 a = ((const f32x4*)src)[2 * i], b = ((const f32x4*)src)[2 * i + 1];
        u32x4 o; o.x = pk2(a[0], a[1]); o.y = pk2(a[2], a[3]); o.z = pk2(b[0], b[1]); o.w = pk2(b[2], b[3]); ((u32x4*)dst)[i] = o; }
}
__device__ __forceinline__ void prologue(const Args& A, ldsp lds, int tid, int wid, int lane) {
    unsigned char* ws = A.ws;
    LAS float* scr = (LAS float*)(lds + wid * 16384);
    const int gw = blockIdx.x * 8 + wid, NGW = gridDim.x * 8;
    constexpr int I0 = 16 * (WIN0 / 32), I1 = 16 * (WIN1 / 32), I2 = 16 * (WIN2 / 32), I3 = I2, IO = 16 * 32, IKV = 16 * 16, IP = 3 * 6, IG = 2 * 4;
    constexpr int NIT = I0 + I1 + I2 + I3 + 4 * IO + IKV + 4 * IP + 12 * IG;
    for (int it = gw; it < NIT; it += NGW) {
        int r = it;
        if (r < I0) { transpose_item(A.in[7], D, WIN0, (bf16_t*)(ws + WS_WIN0), scr, r, lane); continue; } r -= I0;
        if (r < I1) { transpose_item(A.in[10], D, WIN1, (bf16_t*)(ws + WS_WIN1), scr, r, lane); continue; } r -= I1;
        if (r < I2) { transpose_item(A.in[12], D, WIN2, (bf16_t*)(ws + WS_WIN2), scr, r, lane); continue; } r -= I2;
        if (r < I3) { transpose_item(A.in[15], D, WIN3, (bf16_t*)(ws + WS_WIN3), scr, r, lane); continue; } r -= I3;
        if (r < 4 * IO) { const int l = r / IO; transpose_item(A.in[5] + (size_t)l * D * D, D, D, (bf16_t*)(ws + WS_WOUT) + (size_t)l * D * D, scr, r % IO, lane); continue; } r -= 4 * IO;
        if (r < IKV) { transpose_item(A.in[2], D, 512, (bf16_t*)(ws + WS_WKV), scr, r, lane); continue; } r -= IKV;
        if (r < 4 * IP) { const int g = r / IP; transpose_item(A.in[13] + g * 192 * 192, 192, 192, (bf16_t*)(ws + WS_WPT) + g * 192 * 192, scr, r % IP, lane); continue; } r -= 4 * IP;
        { const int g = r / IG, hh = g % 6; const bool ga = g >= 6;
          transpose_item((ga ? A.in[20] : A.in[18]) + hh * 16384, 128, 128, (bf16_t*)(ws + (ga ? WS_WGA : WS_WGX)) + hh * 16384, scr, r % IG, lane); }
    }
    const size_t gtid = (size_t)blockIdx.x * 512 + tid, nthr = (size_t)gridDim.x * 512;
    cvt_rows(A.in[0], (bf16_t*)(ws + WS_XN), (size_t)M * D / 8, gtid, nthr);
    cvt_rows(A.in[1], (bf16_t*)(ws + WS_MEMB), (size_t)512 * D / 8, gtid, nthr);
    for (size_t i = gtid; i < 6 * 128 * 128 / 8; i += nthr) { const int t = (int)((i >> 4) & 127), s0 = (int)(i & 15) * 8;
        const f32x4 a = ((const f32x4*)A.in[8])[2 * i], b = ((const f32x4*)A.in[8])[2 * i + 1]; float v[8] = {a[0], a[1], a[2], a[3], b[0], b[1], b[2], b[3]};
#pragma unroll
        for (int e = 0; e < 8; ++e) v[e] = (s0 + e <= t) ? v[e] : 0.f;
        u32x4 o; o.x = pk2(v[0], v[1]); o.y = pk2(v[2], v[3]); o.z = pk2(v[4], v[5]); o.w = pk2(v[6], v[7]); ((u32x4*)(ws + WS_WSB))[i] = o; }
}

__device__ __forceinline__ float wave_sum(float v) {
#pragma unroll
    for (int o = 1; o < 64; o <<= 1) v += __shfl_xor(v, o);
    return v;
}
__device__ __forceinline__ void ln_phase(float* X, const float* g, const float* b, bf16_t* XN, int wid, int lane) {
    const int gw = blockIdx.x * 8 + wid, NGW = gridDim.x * 8;
    f32x4 gv[4], bv[4];
#pragma unroll
    for (int j = 0; j < 4; ++j) { gv[j] = ((const f32x4*)g)[lane + 64 * j]; bv[j] = ((const f32x4*)b)[lane + 64 * j]; }
    for (int m = gw; m < M; m += NGW) {
        f32x4* xr = (f32x4*)(X + (size_t)m * D) + lane;
        f32x4 v[4]; float s = 0.f;
#pragma unroll
        for (int j = 0; j < 4; ++j) { v[j] = xr[64 * j]; s += (v[j][0] + v[j][1]) + (v[j][2] + v[j][3]); }
        const float mean = wave_sum(s) * (1.f / D); float s2 = 0.f;
#pragma unroll
        for (int j = 0; j < 4; ++j) { v[j] = v[j] - mean; s2 += (v[j][0] * v[j][0] + v[j][1] * v[j][1]) + (v[j][2] * v[j][2] + v[j][3] * v[j][3]); }
        const float rstd = 1.f / sqrtf(wave_sum(s2) * (1.f / D) + LN_EPS);
#pragma unroll
        for (int j = 0; j < 4; ++j) { const f32x4 y = v[j] * rstd * gv[j] + bv[j]; xr[64 * j] = y;
            if (XN) { u32x2 w; w.x = pk2(y[0], y[1]); w.y = pk2(y[2], y[3]); ((u32x2*)(XN + (size_t)m * D))[lane + 64 * j] = w; } }
    }
}

__device__ __forceinline__ void xattn_unit(ldsp lds, const bf16_t* proj, int ldp, int qoff, int goff, const bf16_t* KB, const bf16_t* VT, bf16_t* MIXED, int unit, int wid, int lane) {
    const int fr = lane & 15, fq = lane >> 4;
    const int tt = unit >> 2, h = unit & 3, t0 = tt * 128 + wid * 16, b = t0 >> 13;
    __syncthreads();
    ldsp PW = lds + wid * (16 * 264 * 2);
    const bf16_t* qp = proj + (size_t)(t0 + fr) * ldp + qoff + h * 64 + 8 * fq;
    const bf16x8 q0 = ld8(qp), q1 = ld8(qp + 32);
    const bf16_t* kp = KB + (size_t)(b * 256 + fr) * 256 + h * 64 + 8 * fq;
    f32x4 s[16];
#pragma unroll
    for (int n = 0; n < 16; ++n) { const bf16x8 k0 = ld8(kp + n * 16 * 256), k1 = ld8(kp + n * 16 * 256 + 32);
        f32x4 z = {0.f, 0.f, 0.f, 0.f}; z = MFMA16(k0, q0, z); s[n] = MFMA16(k1, q1, z); }
    float mx = -3.0e38f;
#pragma unroll
    for (int n = 0; n < 16; ++n)
#pragma unroll
        for (int r = 0; r < 4; ++r) mx = fmaxf(mx, s[n][r]);
    mx = fmaxf(mx, __shfl_xor(mx, 16)); mx = fmaxf(mx, __shfl_xor(mx, 32));
    float sum = 0.f;
#pragma unroll
    for (int n = 0; n < 16; ++n) {
#pragma unroll
        for (int r = 0; r < 4; ++r) { const float p = __expf((s[n][r] - mx) * 0.125f); sum += p; s[n][r] = p; }
        u32x2 w; w.x = pk2(s[n][0], s[n][1]); w.y = pk2(s[n][2], s[n][3]);
        *(LAS u32x2*)(PW + (fr * 264 + 16 * n + 4 * fq) * 2) = w; }
    sum += __shfl_xor(sum, 16); sum += __shfl_xor(sum, 32);
    __builtin_amdgcn_wave_barrier(); asm volatile("s_waitcnt lgkmcnt(0)" ::: "memory");
    f32x4 o[4];
#pragma unroll
    for (int n = 0; n < 4; ++n) o[n] = (f32x4){0.f, 0.f, 0.f, 0.f};
    const bf16_t* vp = VT + (size_t)(b * 256 + h * 64 + fr) * 256 + 8 * fq;
#pragma unroll
    for (int kk = 0; kk < 8; ++kk) { const bf16x8 pf = lds8(PW, fr * 264 + 32 * kk + 8 * fq);
#pragma unroll
        for (int n = 0; n < 4; ++n) { const bf16x8 vf = ld8(vp + n * 16 * 256 + 32 * kk); o[n] = MFMA16(vf, pf, o[n]); } }
    const float inv = 1.0f / sum;
    const size_t row = (size_t)(t0 + fr);
#pragma unroll
    for (int n = 0; n < 4; ++n) { const int col = 768 + h * 64 + 16 * n + 4 * fq;
        const u32x2 gw = *(const u32x2*)(proj + row * ldp + goff + col);
        const float g0 = siluf_(lo16(gw.x)), g1 = siluf_(hi16(gw.x)), g2 = siluf_(lo16(gw.y)), g3 = siluf_(hi16(gw.y));
        u32x2 w; w.x = pk2(o[n][0] * inv * g0, o[n][1] * inv * g1); w.y = pk2(o[n][2] * inv * g2, o[n][3] * inv * g3);
        *(u32x2*)(MIXED + row * D + col) = w; }
}

__device__ __forceinline__ void gmlp_unit(ldsp lds, const bf16_t* proj, const bf16_t* WsB, const float* b_s, bf16_t* MIXED, int unit, int tid, int wid, int lane) {
    constexpr int ldp = WIN0, VP = 136;
    const int fr = lane & 15, fq = lane >> 4;
    const int ch = unit / 6, g = unit % 6, row0 = ch * 128;
    __syncthreads();
    {
        const int s = tid >> 2, q = tid & 3;
        const bf16_t* vp = proj + (size_t)(row0 + s) * ldp + 768 + g * 128 + q * 32;
        float x[32]; float sum = 0.f;
#pragma unroll
        for (int i = 0; i < 4; ++i) { const bf16x8 v = ld8(vp + 8 * i);
#pragma unroll
            for (int e = 0; e < 8; ++e) { const float f = geluf_(bf2f((unsigned short)v[e])); x[8 * i + e] = f; sum += f; } }
        sum += __shfl_xor(sum, 1); sum += __shfl_xor(sum, 2);
        const float mean = sum * (1.f / 128.f); float sq = 0.f;
#pragma unroll
        for (int i = 0; i < 32; ++i) { x[i] -= mean; sq += x[i] * x[i]; }
        sq += __shfl_xor(sq, 1); sq += __shfl_xor(sq, 2);
        const float rstd = 1.f / sqrtf(sq * (1.f / 128.f) + LN_EPS);
#pragma unroll
        for (int i = 0; i < 32; ++i) *(LAS unsigned short*)(lds + ((32 * q + i) * VP + s) * 2) = (unsigned short)f2bf(x[i] * rstd);
    }
    __syncthreads();
    f32x4 acc[8];
#pragma unroll
    for (int n = 0; n < 8; ++n) acc[n] = (f32x4){0.f, 0.f, 0.f, 0.f};
    const int nk = (wid >> 1) + 1;
    const bf16_t* wp = WsB + (size_t)(g * 128 + wid * 16 + fr) * 128 + 8 * fq;
    for (int kk = 0; kk < nk; ++kk) { const bf16x8 wf = ld8(wp + 32 * kk);
#pragma unroll
        for (int n = 0; n < 8; ++n) { const bf16x8 vf = lds8(lds, (16 * n + fr) * VP + 32 * kk + 8 * fq); acc[n] = MFMA16(vf, wf, acc[n]); } }
    const size_t row = (size_t)(row0 + wid * 16 + fr); const float bs = b_s[g * 128 + wid * 16 + fr];
#pragma unroll
    for (int n = 0; n < 8; ++n) { const int c = g * 128 + 16 * n + 4 * fq;
        const u32x2 uw = *(const u32x2*)(proj + row * ldp + c), gw = *(const u32x2*)(proj + row * ldp + 1792 + c);
        const float o0 = (acc[n][0] + bs) * geluf_(lo16(uw.x)) * siluf_(lo16(gw.x)), o1 = (acc[n][1] + bs) * geluf_(hi16(uw.x)) * siluf_(hi16(gw.x));
        const float o2 = (acc[n][2] + bs) * geluf_(lo16(uw.y)) * siluf_(lo16(gw.y)), o3 = (acc[n][3] + bs) * geluf_(hi16(uw.y)) * siluf_(hi16(gw.y));
        u32x2 w; w.x = pk2(o0, o1); w.y = pk2(o2, o3); *(u32x2*)(MIXED + row * D + c) = w; }
}

struct HgGate { float lf[16]; float kk[16]; float gmid, gend; };
__device__ __forceinline__ void hgrn_gate(HgGate& G, ldsp lds, const bf16_t* proj, const float* lbl, int row0, int h, int k, int j) {
    constexpr int ldp = WIN1;
    const int col = h * 128 + k;
    const float l0 = lbl[col], l1 = lbl[768 + col], l2 = lbl[1536 + col], l3 = lbl[2304 + col];
    const float mxl = fmaxf(fmaxf(l0, l1), fmaxf(l2, l3));
    const float e0 = __expf(l0 - mxl), e1 = __expf(l1 - mxl), e2 = __expf(l2 - mxl), e3 = __expf(l3 - mxl);
    const float lb = e1 / (e0 + e1 + e2 + e3);
    float run = 0.f;
    const bf16_t* fp = proj + (size_t)(row0 + 16 * j) * ldp + 768 + col;
#pragma unroll
    for (int i = 0; i < 16; ++i) { const float x = bf2f(fp[(size_t)i * ldp]); const float f = lb + (1.f - lb) * sigmoidf_(x); G.kk[i] = 1.f - f; run += __logf(f); G.lf[i] = run; }
    LAS float* TOT = (LAS float*)lds;
    TOT[j * 128 + k] = run;
    __syncthreads();
    const float t0 = TOT[k], t1 = TOT[128 + k], t2 = TOT[256 + k], t3 = TOT[384 + k];
    const float pre = (j > 0 ? t0 : 0.f) + (j > 1 ? t1 : 0.f) + (j > 2 ? t2 : 0.f);
#pragma unroll
    for (int i = 0; i < 16; ++i) G.lf[i] += pre;
    G.gmid = t0 + t1; G.gend = (t0 + t1) + (t2 + t3);
}
__device__ __forceinline__ void hgrn_store_vt(ldsp VTp, const bf16_t* proj, int row0, int h, int k, int j) {
    constexpr int ldp = WIN1;
    const bf16_t* ip = proj + (size_t)(row0 + 16 * j) * ldp + 1536 + h * 128 + k;
    unsigned w[8];
#pragma unroll
    for (int i = 0; i < 8; ++i) w[i] = (unsigned)ip[(size_t)(2 * i) * ldp] | ((unsigned)ip[(size_t)(2 * i + 1) * ldp] << 16);
    *(LAS u32x4*)(VTp + (k * 72 + 16 * j) * 2) = (u32x4){w[0], w[1], w[2], w[3]};
    *(LAS u32x4*)(VTp + (k * 72 + 16 * j + 8) * 2) = (u32x4){w[4], w[5], w[6], w[7]};
}
__device__ __forceinline__ void hgrn_b1_unit(ldsp lds, const bf16_t* proj, const float* lbl, bf16_t* SLOC, float* DEC, int unit, int tid, int wid, int lane) {
    const int fr = lane & 15, fq = lane >> 4;
    const int bh = unit >> 7, seg = unit & 127, b = bh / 6, h = bh % 6, row0 = b * SEQ + seg * 64;
    const int k = tid & 127, j = tid >> 7;
    ldsp KET = lds + 4096, VTp = lds + 4096 + 18432;
    __syncthreads();
    HgGate G; hgrn_gate(G, lds, proj, lbl, row0, h, k, j);
    {
        unsigned w[8];
#pragma unroll
        for (int i = 0; i < 8; ++i) w[i] = pk2(G.kk[2 * i] * __expf(G.gend - G.lf[2 * i]), G.kk[2 * i + 1] * __expf(G.gend - G.lf[2 * i + 1]));
        *(LAS u32x4*)(KET + (k * 72 + 16 * j) * 2) = (u32x4){w[0], w[1], w[2], w[3]};
        *(LAS u32x4*)(KET + (k * 72 + 16 * j + 8) * 2) = (u32x4){w[4], w[5], w[6], w[7]};
    }
    hgrn_store_vt(VTp, proj, row0, h, k, j);
    if (j == 0) DEC[(size_t)unit * 128 + k] = __expf(G.gend);
    __syncthreads();
    f32x4 acc[8];
#pragma unroll
    for (int n = 0; n < 8; ++n) acc[n] = (f32x4){0.f, 0.f, 0.f, 0.f};
#pragma unroll
    for (int kk = 0; kk < 2; ++kk) { const bf16x8 xf = lds8(VTp, (16 * wid + fr) * 72 + 32 * kk + 8 * fq);
#pragma unroll
        for (int n = 0; n < 8; ++n) { const bf16x8 wf = lds8(KET, (16 * n + fr) * 72 + 32 * kk + 8 * fq); acc[n] = MFMA16(wf, xf, acc[n]); } }
    bf16_t* sp = SLOC + (size_t)unit * 16384 + (16 * wid + fr) * 128 + 4 * fq;
#pragma unroll
    for (int n = 0; n < 8; ++n) { u32x2 w; w.x = pk2(acc[n][0], acc[n][1]); w.y = pk2(acc[n][2], acc[n][3]); *(u32x2*)(sp + 16 * n) = w; }
}
__device__ __forceinline__ void hgrn_scan(bf16_t* SLOC, const float* DEC, int tid) {
    const int nthr = gridDim.x * 512;
    for (int idx = blockIdx.x * 512 + tid; idx < 12 * 8192; idx += nthr) {
        const int bh = idx >> 13, e2 = idx & 8191, k = (2 * e2) & 127;
        unsigned* p = (unsigned*)(SLOC + (size_t)(bh * 128) * 16384) + e2;
        const float* dp = DEC + (size_t)(bh * 128) * 128 + k;
        float r0 = 0.f, r1 = 0.f;
        for (int s0 = 0; s0 < 128; s0 += 8) {
            unsigned x[8]; f32x2 d[8];
#pragma unroll
            for (int i = 0; i < 8; ++i) { x[i] = p[(size_t)(s0 + i) * 8192]; d[i] = *(const f32x2*)(dp + (s0 + i) * 128); }
#pragma unroll
            for (int i = 0; i < 8; ++i) { p[(size_t)(s0 + i) * 8192] = pk2(r0, r1); r0 = d[i][0] * r0 + lo16(x[i]); r1 = d[i][1] * r1 + hi16(x[i]); }
        }
    }
}
__device__ __forceinline__ void hgrn_b3_unit(ldsp lds, const bf16_t* proj, const float* lbl, const bf16_t* SIN, const float* norm_g, bf16_t* MIXED, int unit, int tid, int wid, int lane) {
    constexpr int ldp = WIN1;
    const int fr = lane & 15, fq = lane >> 4;
    const int bh = unit >> 7, seg = unit & 127, b = bh / 6, h = bh % 6, row0 = b * SEQ + seg * 64;
    const int k = tid & 127, j = tid >> 7;
    ldsp Qm = lds + 4096, QS = lds + 21504, Km = lds + 38912, VTp = lds + 56320, PL = lds + 74752;
    LAS float* SSQ = (LAS float*)(lds + 2048);
    __syncthreads();
    HgGate G; hgrn_gate(G, lds, proj, lbl, row0, h, k, j);
    {
        const bf16_t* qp = proj + (size_t)(row0 + 16 * j) * ldp + h * 128 + k;
#pragma unroll
        for (int i = 0; i < 16; ++i) { const float sq = siluf_(bf2f(qp[(size_t)i * ldp])); const int e = (16 * j + i) * 136 + k;
            *(LAS unsigned short*)(Qm + e * 2) = (unsigned short)f2bf(sq * __expf(G.lf[i] - G.gmid));
            *(LAS unsigned short*)(QS + e * 2) = (unsigned short)f2bf(sq * __expf(G.lf[i]));
            *(LAS unsigned short*)(Km + e * 2) = (unsigned short)f2bf(G.kk[i] * __expf(G.gmid - G.lf[i])); }
    }
    hgrn_store_vt(VTp, proj, row0, h, k, j);
    __syncthreads();
    const int mt = wid >> 1;
    {
#pragma unroll
        for (int e = 0; e < 2; ++e) { const int nt = 2 * (wid & 1) + e; f32x4 acc = {0.f, 0.f, 0.f, 0.f};
            if (nt <= mt) {
#pragma unroll
                for (int kk = 0; kk < 4; ++kk) { const bf16x8 xf = lds8(Qm, (16 * mt + fr) * 136 + 32 * kk + 8 * fq), wf = lds8(Km, (16 * nt + fr) * 136 + 32 * kk + 8 * fq); acc = MFMA16(wf, xf, acc); } }
            const int t = 16 * mt + fr, s0 = 16 * nt + 4 * fq; float p[4];
#pragma unroll
            for (int r = 0; r < 4; ++r) p[r] = (nt <= mt && s0 + r <= t) ? acc[r] : 0.f;
            u32x2 w; w.x = pk2(p[0], p[1]); w.y = pk2(p[2], p[3]); *(LAS u32x2*)(PL + (t * 72 + s0) * 2) = w; }
    }
    __syncthreads();
    f32x4 o[4];
#pragma unroll
    for (int e = 0; e < 4; ++e) o[e] = (f32x4){0.f, 0.f, 0.f, 0.f};
    const int nb = 4 * (wid & 1);
#pragma unroll
    for (int kk = 0; kk < 2; ++kk) { const bf16x8 xf = lds8(PL, (16 * mt + fr) * 72 + 32 * kk + 8 * fq);
#pragma unroll
        for (int e = 0; e < 4; ++e) { const bf16x8 wf = lds8(VTp, (16 * (nb + e) + fr) * 72 + 32 * kk + 8 * fq); o[e] = MFMA16(wf, xf, o[e]); } }
    const bf16_t* sp = SIN + (size_t)unit * 16384 + (size_t)(16 * nb + fr) * 128 + 8 * fq;
#pragma unroll
    for (int kk = 0; kk < 4; ++kk) { const bf16x8 xf = lds8(QS, (16 * mt + fr) * 136 + 32 * kk + 8 * fq);
#pragma unroll
        for (int e = 0; e < 4; ++e) { const bf16x8 wf = ld8(sp + e * 16 * 128 + 32 * kk); o[e] = MFMA16(wf, xf, o[e]); } }
    float ss = 0.f;
#pragma unroll
    for (int e = 0; e < 4; ++e)
#pragma unroll
        for (int r = 0; r < 4; ++r) ss += o[e][r] * o[e][r];
    ss += __shfl_xor(ss, 16); ss += __shfl_xor(ss, 32);
    const int t = 16 * mt + fr;
    if (fq == 0) SSQ[t * 2 + (wid & 1)] = ss;
    __syncthreads();
    const float rinv = 1.f / sqrtf((SSQ[t * 2] + SSQ[t * 2 + 1]) * (1.f / 128.f) + RMS_EPS);
    const size_t row = (size_t)(row0 + t);
#pragma unroll
    for (int e = 0; e < 4; ++e) { const int c = h * 128 + 16 * (nb + e) + 4 * fq;
        const f32x4 ng = *(const f32x4*)(norm_g + c); const u32x2 gw = *(const u32x2*)(proj + row * ldp + 2560 + c);
        u32x2 w; w.x = pk2(o[e][0] * rinv * ng[0] * siluf_(lo16(gw.x)), o[e][1] * rinv * ng[1] * siluf_(hi16(gw.x)));
        w.y = pk2(o[e][2] * rinv * ng[2] * siluf_(lo16(gw.y)), o[e][3] * rinv * ng[3] * siluf_(hi16(gw.y)));
        *(u32x2*)(MIXED + row * D + c) = w; }
}

__device__ __forceinline__ void pool_unit(ldsp lds, const bf16_t* proj, const bf16_t* WpT, const float* scale, bf16_t* MIXED, int unit, int tid, int wid, int lane) {
    constexpr int ldp = WIN2, DP = 200;
    const int fr = lane & 15, fq = lane >> 4;
    const int tile = unit >> 2, g = unit & 3, row0 = tile * 128, w = 2 << g;
    __syncthreads();
    for (int it = tid; it < 128 * 24; it += 512) { const int t = it / 24, c8 = it % 24, pos = (row0 + t) & (SEQ - 1);
        const bf16_t* pp = proj + (size_t)(row0 + t) * ldp + g * 192 + 8 * c8;
        const int nwin = (pos + 1 < w) ? pos + 1 : w;
        float sum[8], self[8];
        { const bf16x8 v = ld8(pp);
#pragma unroll
          for (int e = 0; e < 8; ++e) { self[e] = bf2f((unsigned short)v[e]); sum[e] = self[e]; } }
        for (int jj = 1; jj < nwin; ++jj) { const bf16x8 v = ld8(pp - (size_t)jj * ldp);
#pragma unroll
            for (int e = 0; e < 8; ++e) sum[e] += bf2f((unsigned short)v[e]); }
        const float inv = 1.f / (float)nwin;
        u32x4 o; o.x = pk2(sum[0] * inv - self[0], sum[1] * inv - self[1]); o.y = pk2(sum[2] * inv - self[2], sum[3] * inv - self[3]);
        o.z = pk2(sum[4] * inv - self[4], sum[5] * inv - self[5]); o.w = pk2(sum[6] * inv - self[6], sum[7] * inv - self[7]);
        *(LAS u32x4*)(lds + (t * DP + 8 * c8) * 2) = o; }
    __syncthreads();
    f32x4 acc[12];
#pragma unroll
    for (int n = 0; n < 12; ++n) acc[n] = (f32x4){0.f, 0.f, 0.f, 0.f};
    const bf16_t* wp = WpT + (size_t)(g * 192 + fr) * 192 + 8 * fq;
#pragma unroll
    for (int kk = 0; kk < 6; ++kk) { const bf16x8 xf = lds8(lds, (16 * wid + fr) * DP + 32 * kk + 8 * fq);
#pragma unroll
        for (int n = 0; n < 12; ++n) { const bf16x8 wf = ld8(wp + n * 16 * 192 + 32 * kk); acc[n] = MFMA16(wf, xf, acc[n]); } }
    const size_t row = (size_t)(row0 + 16 * wid + fr);
#pragma unroll
    for (int n = 0; n < 12; ++n) { const int c = g * 192 + 16 * n + 4 * fq;
        const f32x4 sc = *(const f32x4*)(scale + c); const u32x2 gw = *(const u32x2*)(proj + row * ldp + 1024 + c);
        u32x2 o; o.x = pk2(acc[n][0] * sc[0] * siluf_(lo16(gw.x)), acc[n][1] * sc[1] * siluf_(hi16(gw.x)));
        o.y = pk2(acc[n][2] * sc[2] * siluf_(lo16(gw.y)), acc[n][3] * sc[3] * siluf_(hi16(gw.y)));
        *(u32x2*)(MIXED + row * D + c) = o; }
}

template <int PASS>
__device__ __forceinline__ void lru_unit(ldsp lds, const bf16_t* proj, const Args& A, const bf16_t* WgxT, const bf16_t* WgaT, f32x2* LSUM, bf16_t* MIXED, int unit, int tid, int wid, int lane) {
    constexpr int ldp = WIN3, XP = 136;
    const int fr = lane & 15, fq = lane >> 4;
    const int tile = unit / 6, h = unit % 6, row0 = tile * 128, b = tile >> 6, ti = tile & 63;
    const float* conv_w = A.in[16]; const float* conv_b = A.in[17]; const float* b_gx = A.in[19]; const float* b_ga = A.in[21]; const float* a_param = A.in[22];
    LAS f32x2* WT = (LAS f32x2*)(lds + 34816); LAS float* HIN = (LAS float*)(lds + 43008);
    __syncthreads();
    if (PASS == 2 && tid < 128) { const f32x2* sp = LSUM + (size_t)(b * 64) * 768 + h * 128 + tid; float H = 0.f;
        for (int t2 = 0; t2 < ti; ++t2) { const f32x2 s = sp[(size_t)t2 * 768]; H = s[0] * H + s[1]; }
        HIN[tid] = H; }
    for (int it = tid; it < 128 * 16; it += 512) { const int t = it >> 4, c8 = it & 15, pos = (row0 + t) & (SEQ - 1), col = h * 128 + 8 * c8;
        float a8[8];
        { const f32x4 c0 = *(const f32x4*)(conv_b + col), c1 = *(const f32x4*)(conv_b + col + 4); a8[0] = c0[0]; a8[1] = c0[1]; a8[2] = c0[2]; a8[3] = c0[3]; a8[4] = c1[0]; a8[5] = c1[1]; a8[6] = c1[2]; a8[7] = c1[3]; }
#pragma unroll
        for (int jj = 0; jj < 4; ++jj) { const int d = 3 - jj;
            if (pos - d >= 0) { const bf16x8 v = ld8(proj + (size_t)(row0 + t - d) * ldp + col);
                const f32x4 w0 = *(const f32x4*)(conv_w + jj * 768 + col), w1 = *(const f32x4*)(conv_w + jj * 768 + col + 4);
                a8[0] += w0[0] * bf2f((unsigned short)v[0]); a8[1] += w0[1] * bf2f((unsigned short)v[1]); a8[2] += w0[2] * bf2f((unsigned short)v[2]); a8[3] += w0[3] * bf2f((unsigned short)v[3]);
                a8[4] += w1[0] * bf2f((unsigned short)v[4]); a8[5] += w1[1] * bf2f((unsigned short)v[5]); a8[6] += w1[2] * bf2f((unsigned short)v[6]); a8[7] += w1[3] * bf2f((unsigned short)v[7]); } }
        u32x4 o; o.x = pk2(a8[0], a8[1]); o.y = pk2(a8[2], a8[3]); o.z = pk2(a8[4], a8[5]); o.w = pk2(a8[6], a8[7]);
        *(LAS u32x4*)(lds + (t * XP + 8 * c8) * 2) = o; }
    __syncthreads();
    f32x4 ax[8], aa[8];
#pragma unroll
    for (int n = 0; n < 8; ++n) { ax[n] = (f32x4){0.f, 0.f, 0.f, 0.f}; aa[n] = (f32x4){0.f, 0.f, 0.f, 0.f}; }
    const bf16_t* wxp = WgxT + (size_t)(h * 128 + fr) * 128 + 8 * fq; const bf16_t* wap = WgaT + (size_t)(h * 128 + fr) * 128 + 8 * fq;
#pragma unroll
    for (int kk = 0; kk < 4; ++kk) { const bf16x8 xf = lds8(lds, (16 * wid + fr) * XP + 32 * kk + 8 * fq);
#pragma unroll
        for (int n = 0; n < 8; ++n) { const bf16x8 wx = ld8(wxp + n * 16 * 128 + 32 * kk), wa = ld8(wap + n * 16 * 128 + 32 * kk); ax[n] = MFMA16(wx, xf, ax[n]); aa[n] = MFMA16(wa, xf, aa[n]); } }
    const int t = 16 * wid + fr, pos = (row0 + t) & (SEQ - 1);
#pragma unroll
    for (int n = 0; n < 8; ++n) { const int j0 = 16 * n + 4 * fq, chn = h * 128 + j0;
        const f32x4 bx = *(const f32x4*)(b_gx + chn), ba = *(const f32x4*)(b_ga + chn), ap = *(const f32x4*)(a_param + chn);
        const u32x2 xw = *(const LAS u32x2*)(lds + (t * XP + j0) * 2); const float xc[4] = {lo16(xw.x), hi16(xw.x), lo16(xw.y), hi16(xw.y)};
#pragma unroll
        for (int r = 0; r < 4; ++r) { const float gx = sigmoidf_(ax[n][r] + bx[r]), ga = sigmoidf_(aa[n][r] + ba[r]);
            const float sp = log1pf(__expf(-ap[r])); const float la = -8.0f * ga * sp; const float a = __expf(la);
            const float mult = (pos == 0) ? 1.0f : sqrtf(-expm1f(2.0f * la));
            aa[n][r] = a; ax[n][r] = mult * gx * xc[r]; } }
#define LRU_STEP(Nn) _Pragma("unroll") for (int n = 0; n < 8; ++n) _Pragma("unroll") for (int r = 0; r < 4; ++r) { \
        const float ap_ = row_shr<Nn>(1.0f, aa[n][r]), bp_ = row_shr<Nn>(0.0f, ax[n][r]); ax[n][r] = aa[n][r] * bp_ + ax[n][r]; aa[n][r] = aa[n][r] * ap_; }
    LRU_STEP(1) LRU_STEP(2) LRU_STEP(4) LRU_STEP(8)
#undef LRU_STEP
    if (fr == 15) {
#pragma unroll
        for (int n = 0; n < 8; ++n)
#pragma unroll
            for (int r = 0; r < 4; ++r) WT[wid * 128 + 16 * n + 4 * fq + r] = (f32x2){aa[n][r], ax[n][r]}; }
    __syncthreads();
    if (PASS == 1) {
        if (tid < 128) { float Aa = 1.f, H = 0.f;
#pragma unroll
            for (int w2 = 0; w2 < 8; ++w2) { const f32x2 s = WT[w2 * 128 + tid]; H = s[0] * H + s[1]; Aa *= s[0]; }
            LSUM[(size_t)(b * 64 + ti) * 768 + h * 128 + tid] = (f32x2){Aa, H}; }
    } else {
        const size_t row = (size_t)(row0 + t);
#pragma unroll
        for (int n = 0; n < 8; ++n) { const int j0 = 16 * n + 4 * fq; float hv[4];
#pragma unroll
            for (int r = 0; r < 4; ++r) { float Hs = HIN[j0 + r];
                for (int w2 = 0; w2 < wid; ++w2) { const f32x2 s = WT[w2 * 128 + j0 + r]; Hs = s[0] * Hs + s[1]; }
                hv[r] = ax[n][r] + aa[n][r] * Hs; }
            const int c = h * 128 + j0; const u32x2 gw = *(const u32x2*)(proj + row * ldp + 1024 + c);
            u32x2 o; o.x = pk2(hv[0] * siluf_(lo16(gw.x)), hv[1] * siluf_(hi16(gw.x))); o.y = pk2(hv[2] * siluf_(lo16(gw.y)), hv[3] * siluf_(hi16(gw.y)));
            *(u32x2*)(MIXED + row * D + c) = o; }
    }
}


#define IN(k) (lo <= (k) && (k) < hi)
#define SEAM(k) do { if (IN(k) && IN((k) + 1)) grid.sync(); } while (0)
template <int L>
__device__ __forceinline__ void run_layer(const Args& args, ldsp lds, cg::grid_group& grid, int tid, int wid, int lane) {
    const int G = gridDim.x, bx = blockIdx.x;
    unsigned char* ws = args.ws;
    bf16_t* XN = (bf16_t*)(ws + WS_XN); bf16_t* PROJ = (bf16_t*)(ws + WS_PROJ); bf16_t* MIXED = (bf16_t*)(ws + WS_MIXED);
    bf16_t* KB = (bf16_t*)(ws + WS_KB); bf16_t* VT = (bf16_t*)(ws + WS_VT);
    bf16_t* STATE = (bf16_t*)(ws + WS_STATE); float* DEC = (float*)(ws + WS_DEC); f32x2* LSUM = (f32x2*)(ws + WS_LSUM);
    float* X = args.out;
    const int lo = args.ph_lo, hi = args.ph_hi;

        constexpr int p0 = 1 + (L == 0 ? 0 : (L == 1 ? 4 : (L == 2 ? 10 : 14)));
        constexpr int win = (L == 0) ? WIN0 : (L == 1 ? WIN1 : WIN2);
        constexpr size_t wsw = (L == 0) ? WS_WIN0 : (L == 1 ? WS_WIN1 : (L == 2 ? WS_WIN2 : WS_WIN3));
        constexpr int qoff = win - 1280, goff = win - 1024;
        if (IN(p0)) {
            if (L == 0) { pg8::Gemm g{(const bf16_t*)(ws + WS_MEMB), (const bf16_t*)(ws + WS_WKV), 512, 512, D}; pg8::StaticOrder S; S.init(512, 512, G, G - 1 - bx);
                EpiKV E{KB, VT}; pg8::gemm_phase<EpiKV, pg8::StaticOrder, false, true>(lds, g, S, E); __syncthreads(); }
            pg8::Gemm g{XN, (const bf16_t*)(ws + wsw), M, win, D}; pg8::StaticOrder S; S.init(M, win, G, bx);
            pg8::EpiBf16<0> E{PROJ, win, nullptr, 0, 0, 1.f};
            pg8::gemm_phase<pg8::EpiBf16<0>, pg8::StaticOrder, true, true>(lds, g, S, E);
        }
        SEAM(p0);
        int p = p0 + 1;
        if (L == 0) {
            if (IN(p)) { for (int u = bx; u < 512 + 768; u += G) { if (u < 512) { if (EN_XATTN) xattn_unit(lds, PROJ, win, qoff, goff, KB, VT, MIXED, u, wid, lane); }
                    else if (EN_GMLP) gmlp_unit(lds, PROJ, (const bf16_t*)(ws + WS_WSB), args.in[9], MIXED, u - 512, tid, wid, lane); } }
            SEAM(p); ++p;
        } else if (L == 1) {
            if (IN(p)) { for (int u = bx; u < 512 + 1536; u += G) { if (u < 512) { if (EN_XATTN) xattn_unit(lds, PROJ, win, qoff, goff, KB, VT, MIXED, u, wid, lane); }
                    else if (EN_HGRN) hgrn_b1_unit(lds, PROJ, args.in[6], STATE, DEC, u - 512, tid, wid, lane); } }
            SEAM(p); ++p;
            if (IN(p) && EN_HGRN) hgrn_scan(STATE, DEC, tid);
            SEAM(p); ++p;
            if (IN(p)) { for (int u = bx; u < 1536; u += G) if (EN_HGRN) hgrn_b3_unit(lds, PROJ, args.in[6], STATE, args.in[11], MIXED, u, tid, wid, lane); }
            SEAM(p); ++p;
        } else if (L == 2) {
            if (IN(p)) { for (int u = bx; u < 512 + 512; u += G) { if (u < 512) { if (EN_XATTN) xattn_unit(lds, PROJ, win, qoff, goff, KB, VT, MIXED, u, wid, lane); }
                    else if (EN_POOL) pool_unit(lds, PROJ, (const bf16_t*)(ws + WS_WPT), args.in[14], MIXED, u - 512, tid, wid, lane); } }
            SEAM(p); ++p;
        } else {
            if (IN(p)) { for (int u = bx; u < 512 + 768; u += G) { if (u < 512) { if (EN_XATTN) xattn_unit(lds, PROJ, win, qoff, goff, KB, VT, MIXED, u, wid, lane); }
                    else if (EN_LRU) lru_unit<1>(lds, PROJ, args, (const bf16_t*)(ws + WS_WGX), (const bf16_t*)(ws + WS_WGA), LSUM, MIXED, u - 512, tid, wid, lane); } }
            SEAM(p); ++p;
            if (IN(p)) { for (int u = bx; u < 768; u += G) if (EN_LRU) lru_unit<2>(lds, PROJ, args, (const bf16_t*)(ws + WS_WGX), (const bf16_t*)(ws + WS_WGA), LSUM, MIXED, u, tid, wid, lane); }
            SEAM(p); ++p;
        }
        if (IN(p)) { __syncthreads();
            pg8::Gemm g{MIXED, (const bf16_t*)(ws + WS_WOUT) + (size_t)L * D * D, M, D, D}; pg8::StaticOrder S; S.init(M, D, G, bx);
            EpiResid E{L == 0 ? args.in[0] : X, X, ALPHA};
            pg8::gemm_phase<EpiResid, pg8::StaticOrder, true, true>(lds, g, S, E); }
        SEAM(p); ++p;
        if (IN(p) && EN_LN) ln_phase(X, args.in[3] + L * D, args.in[4] + L * D, L < 3 ? XN : nullptr, wid, lane);
        SEAM(p); ++p;
    }
#undef IN
#undef SEAM
__global__ void __launch_bounds__(512, 2) fwd_mega(Args args) {
    extern __shared__ __attribute__((aligned(16))) unsigned char lds_raw[];
    ldsp lds = (ldsp)lds_raw;
    cg::grid_group grid = cg::this_grid();
    const int tid = threadIdx.x, wid = __builtin_amdgcn_readfirstlane(tid >> 6), lane = tid & 63;
    const int G = gridDim.x, bx = blockIdx.x;
    unsigned char* ws = args.ws;
    bf16_t* XN = (bf16_t*)(ws + WS_XN); bf16_t* PROJ = (bf16_t*)(ws + WS_PROJ); bf16_t* MIXED = (bf16_t*)(ws + WS_MIXED);
    bf16_t* KB = (bf16_t*)(ws + WS_KB); bf16_t* VT = (bf16_t*)(ws + WS_VT);
    bf16_t* STATE = (bf16_t*)(ws + WS_STATE); float* DEC = (float*)(ws + WS_DEC); f32x2* LSUM = (f32x2*)(ws + WS_LSUM);
    float* X = args.out;
    const int lo = args.ph_lo, hi = args.ph_hi;
#define IN(k) (lo <= (k) && (k) < hi)
#define SEAM(k) do { if (IN(k) && IN((k) + 1)) grid.sync(); } while (0)

    if (IN(0) && EN_PRO) { prologue(args, lds, tid, wid, lane); }
    SEAM(0);
    run_layer<0>(args, lds, grid, tid, wid, lane);
    run_layer<1>(args, lds, grid, tid, wid, lane);
    run_layer<2>(args, lds, grid, tid, wid, lane);
    run_layer<3>(args, lds, grid, tid, wid, lane);
#undef IN
#undef SEAM
}

extern "C" void kernel_launch(void* const* d_in, const int* in_sizes, int n_in, void* d_out, int out_size, void* d_ws, size_t ws_size, hipStream_t stream) {
    static int grid = 0;
    if (grid == 0) {
        if (n_in != 23 || in_sizes[0] != M * D || out_size != M * D || ws_size < WS_END) { fprintf(stderr, "kernel_launch: unexpected shapes/workspace (n_in %d, ws %zu)\n", n_in, ws_size); grid = -1; return; }
        int dev = 0, cus = 0, per_cu = 0;
        hipGetDevice(&dev); hipDeviceGetAttribute(&cus, hipDeviceAttributeMultiprocessorCount, dev);
        if (hipFuncSetAttribute((const void*)fwd_mega, hipFuncAttributeMaxDynamicSharedMemorySize, LDS_BYTES) != hipSuccess) { fprintf(stderr, "kernel_launch: hipFuncSetAttribute failed\n"); grid = -1; return; }
        if (hipOccupancyMaxActiveBlocksPerMultiprocessor(&per_cu, (const void*)fwd_mega, 512, LDS_BYTES) != hipSuccess || per_cu < 1) { fprintf(stderr, "kernel_launch: occupancy query says %d\n", per_cu); per_cu = 1; }
        (void)hipGetLastError();
        grid = cus * 1;
        if (grid > 256) grid = 256;
    }
    if (grid < 0) return;
    Args a{};
    for (int i = 0; i < 23; ++i) a.in[i] = (const float*)d_in[i];
    a.out = (float*)d_out; a.ws = (unsigned char*)d_ws;
#ifndef N_LAUNCH_PER_PHASE
    a.ph_lo = 0; a.ph_hi = NPH;
    void* kargs[] = {&a};
    hipError_t e = hipLaunchCooperativeKernel((const void*)fwd_mega, dim3(grid), dim3(512), kargs, LDS_BYTES, stream);
    if (e != hipSuccess) fprintf(stderr, "cooperative launch failed: %s (grid %d)\n", hipGetErrorString(e), grid);
#else
    for (int ph = 0; ph < NPH; ++ph) { a.ph_lo = ph; a.ph_hi = ph + 1; void* kargs[] = {&a};
        hipError_t e = hipLaunchCooperativeKernel((const void*)fwd_mega, dim3(grid), dim3(512), kargs, LDS_BYTES, stream);
        if (e != hipSuccess) { fprintf(stderr, "launch %d failed: %s\n", ph, hipGetErrorString(e)); break; } }
#endif
}
```
